# Optimizing an MI355X kernel written in HIP

```python
import jax, jax.numpy as jnp
from jax import lax
import numpy as np

D_MODEL = 1024
BATCH = 2
SEQ = 16384
DEPTH = 4

PLE_DIM = 256
EPS = 1e-6

A_GROUPS = 8
A_WIDTH = D_MODEL
CONV_WIDTH = 3
B_GROUPS = 8
B_WIDTH = D_MODEL
B_GDIM = B_WIDTH // B_GROUPS
B_CHUNK = 128
EVEN_IN = 4 * A_WIDTH + 3 * B_WIDTH
EVEN_MIX = A_WIDTH + B_WIDTH
EVEN_SPLITS = [A_WIDTH, 2 * A_WIDTH, 3 * A_WIDTH, 4 * A_WIDTH,
               4 * A_WIDTH + B_WIDTH, 4 * A_WIDTH + 2 * B_WIDTH]

C_HEADS = 8
C_DQK = D_MODEL // C_HEADS
C_DV = 2 * D_MODEL // C_HEADS
C_QK = C_HEADS * C_DQK
C_WIDTH = C_HEADS * C_DV
C_CHUNK = 128
ODD_IN = 2 * C_QK + 3 * C_WIDTH + 2 * C_HEADS
ODD_SPLITS = [C_QK, 2 * C_QK, 2 * C_QK + C_WIDTH, 2 * C_QK + 2 * C_WIDTH, 2 * C_QK + 3 * C_WIDTH]

N_EVEN = (DEPTH + 1) // 2
N_ODD = DEPTH // 2

kernel_name = 'hybrid_conv_gmlp_mlstm_trunk'


def rmsnorm(x, g):
    xf = x.astype(jnp.float32)
    y = xf * lax.rsqrt(jnp.mean(xf * xf, axis=-1, keepdims=True) + EPS)
    return (y * g.astype(jnp.float32)).astype(x.dtype)


def layernorm(x, g, b):
    xf = x.astype(jnp.float32)
    mu = jnp.mean(xf, axis=-1, keepdims=True)
    xc = xf - mu
    y = xc * lax.rsqrt(jnp.mean(xc * xc, axis=-1, keepdims=True) + EPS)
    return (y * g.astype(jnp.float32) + b.astype(jnp.float32)).astype(x.dtype)


def causal_short_conv(z, w):
    seq = z.shape[1]
    zp = jnp.pad(z, ((0, 0), (CONV_WIDTH - 1, 0), (0, 0)))
    out = w[CONV_WIDTH - 1] * z
    for j in range(CONV_WIDTH - 1):
        out = out + w[j] * zp[:, j:j + seq]
    return out


def conv_gmlp_mixer(xn, w_in, conv_w, ln_g, ln_b, w_s, b_s, w_out):
    bsz, seq, _ = xn.shape
    n_chunks = seq // B_CHUNK
    proj = xn @ w_in
    a_b, a_c, a_x, a_gate, b_u, b_v, b_gate = jnp.split(proj, EVEN_SPLITS, axis=-1)
    y_a = a_b * causal_short_conv(a_c * a_x, conv_w) * jax.nn.silu(a_gate)
    v = layernorm(b_v, ln_g, ln_b).reshape(bsz, n_chunks, B_CHUNK, B_GROUPS, B_GDIM)
    causal = jnp.tril(jnp.ones((B_CHUNK, B_CHUNK), dtype=bool))
    w_causal = jnp.where(causal, w_s, jnp.zeros_like(w_s))
    s = jnp.einsum('gts,bnsgc->bntgc', w_causal, v) + b_s[None, None, :, :, None]
    y_b = b_u * s.reshape(bsz, seq, B_WIDTH) * jax.nn.silu(b_gate)
    return jnp.concatenate([y_a, y_b], axis=-1) @ w_out


def mlstm_mixer(xn, w_in, b_if, mh_g, w_out):
    bsz, seq, _ = xn.shape
    nc, L, H = seq // C_CHUNK, C_CHUNK, C_HEADS
    f32 = jnp.float32
    proj = xn @ w_in
    q, k, v, o, z, gif = jnp.split(proj, ODD_SPLITS, axis=-1)
    gif = gif.astype(f32) + b_if.astype(f32)
    i_pre = gif[..., :H].reshape(bsz, nc, L, H)
    log_f = jax.nn.log_sigmoid(gif[..., H:]).reshape(bsz, nc, L, H)
    q = q.astype(f32).reshape(bsz, nc, L, H, C_DQK) * (C_DQK ** -0.5)
    k = k.astype(f32).reshape(bsz, nc, L, H, C_DQK)
    v = v.astype(f32).reshape(bsz, nc, L, H, C_DV)

    b = jnp.cumsum(log_f, axis=2)
    g = b[:, :, -1]
    a = g[:, :, None] - b + i_pre

    def chunk_step(carry, xs):
        c_st, n_st, m_st = carry
        k_c, v_c, a_c, g_c = xs
        m_new = jnp.maximum(g_c + m_st, jnp.max(a_c, axis=1))
        decay = jnp.exp(g_c + m_st - m_new)
        w = jnp.exp(a_c - m_new[:, None])
        c_new = decay[..., None, None] * c_st + jnp.einsum('blh,blhk,blhv->bhkv', w, k_c, v_c)
        n_new = decay[..., None] * n_st + jnp.einsum('blh,blhk->bhk', w, k_c)
        return (c_new, n_new, m_new), (c_st, n_st, m_st)

    init = (jnp.zeros((bsz, H, C_DQK, C_DV), f32), jnp.zeros((bsz, H, C_DQK), f32),
            jnp.zeros((bsz, H), f32))
    xs = (jnp.moveaxis(k, 1, 0), jnp.moveaxis(v, 1, 0), jnp.moveaxis(a, 1, 0), jnp.moveaxis(g, 1, 0))
    _, (c_all, n_all, m_all) = lax.scan(chunk_step, init, xs)
    c_all = jnp.moveaxis(c_all, 0, 1)
    n_all = jnp.moveaxis(n_all, 0, 1)
    m_all = jnp.moveaxis(m_all, 0, 1)

    bt = jnp.moveaxis(b, 3, 2)
    it = jnp.moveaxis(i_pre, 3, 2)
    causal = jnp.tril(jnp.ones((L, L), dtype=bool))
    d = jnp.where(causal, bt[..., :, None] - bt[..., None, :] + it[..., None, :], -jnp.inf)
    m_inter = bt + m_all[..., None]
    m_t = jnp.maximum(m_inter, jnp.max(d, axis=-1))
    p_mat = jnp.exp(d - m_t[..., None]) * jnp.einsum('bnthk,bnshk->bnhts', q, k)
    inter_scale = jnp.exp(m_inter - m_t)
    num = (inter_scale[..., None] * jnp.einsum('bnthk,bnhkv->bnhtv', q, c_all)
           + jnp.einsum('bnhts,bnshv->bnhtv', p_mat, v))
    den = inter_scale * jnp.einsum('bnthk,bnhk->bnht', q, n_all) + jnp.sum(p_mat, axis=-1)
    hc = num / jnp.maximum(jnp.abs(den), jnp.exp(-m_t))[..., None]
    hc = hc * lax.rsqrt(jnp.mean(hc * hc, axis=-1, keepdims=True) + EPS) * mh_g.astype(f32)[:, None, :]
    hc = jnp.moveaxis(hc, 2, 3).reshape(bsz, seq, C_WIDTH).astype(xn.dtype)
    y = hc * jax.nn.sigmoid(o) * jax.nn.silu(z)
    return y @ w_out


def setup_inputs(seed: int = 0) -> dict:
    key = jax.random.key(seed)
    ks = jax.random.split(key, 20)

    def nrm(k, shape, scale):
        return scale * jax.random.normal(k, shape, jnp.float32)

    f_bias = jnp.linspace(3.0, 6.0, C_HEADS, dtype=jnp.float32)
    b_if = jnp.concatenate([nrm(ks[16], (N_ODD, C_HEADS), 0.1),
                            f_bias[None, :] + nrm(ks[17], (N_ODD, C_HEADS), 0.1)], axis=-1)
    return {
        'x': nrm(ks[0], (BATCH, SEQ, D_MODEL), 1.0),
        'p': nrm(ks[1], (DEPTH, BATCH, SEQ, PLE_DIM), 1.0),
        'pre_g': 1.0 + nrm(ks[2], (DEPTH, D_MODEL), 0.02),
        'post_g': 1.0 + nrm(ks[3], (DEPTH, D_MODEL), 0.02),
        'ple_g': 1.0 + nrm(ks[4], (DEPTH, D_MODEL), 0.02),
        'w_ple': nrm(ks[5], (DEPTH, PLE_DIM, D_MODEL), PLE_DIM ** -0.5),
        'w_ple_gate': nrm(ks[6], (DEPTH, D_MODEL, D_MODEL), D_MODEL ** -0.5),
        'even_w_in': nrm(ks[7], (N_EVEN, D_MODEL, EVEN_IN), D_MODEL ** -0.5),
        'even_conv_w': nrm(ks[8], (N_EVEN, CONV_WIDTH, A_WIDTH), CONV_WIDTH ** -0.5),
        'even_ln_g': 1.0 + nrm(ks[9], (N_EVEN, B_WIDTH), 0.02),
        'even_ln_b': nrm(ks[10], (N_EVEN, B_WIDTH), 0.02),
        'even_w_s': nrm(ks[11], (N_EVEN, B_GROUPS, B_CHUNK, B_CHUNK), B_CHUNK ** -0.5),
        'even_b_s': nrm(ks[12], (N_EVEN, B_CHUNK, B_GROUPS), 0.1),
        'even_w_out': nrm(ks[13], (N_EVEN, EVEN_MIX, D_MODEL), EVEN_MIX ** -0.5),
        'odd_w_in': nrm(ks[14], (N_ODD, D_MODEL, ODD_IN), D_MODEL ** -0.5),
        'odd_b_if': b_if,
        'odd_mh_g': 1.0 + nrm(ks[15], (N_ODD, C_HEADS, C_DV), 0.02),
        'odd_w_out': nrm(ks[18], (N_ODD, C_WIDTH, D_MODEL), C_WIDTH ** -0.5),
    }


def reference(x, p, pre_g, post_g, ple_g, w_ple, w_ple_gate, even_w_in, even_conv_w, even_ln_g,
              even_ln_b, even_w_s, even_b_s, even_w_out, odd_w_in, odd_b_if, odd_mh_g, odd_w_out):
    h = x
    for i in range(DEPTH):
        j = i // 2
        xn = rmsnorm(h, pre_g[i])
        if i % 2 == 0:
            y = conv_gmlp_mixer(xn, even_w_in[j], even_conv_w[j], even_ln_g[j], even_ln_b[j],
                                even_w_s[j], even_b_s[j], even_w_out[j])
        else:
            y = mlstm_mixer(xn, odd_w_in[j], odd_b_if[j], odd_mh_g[j], odd_w_out[j])
        h = h + rmsnorm(y, post_g[i])
        gate = jax.nn.sigmoid(rmsnorm(h, ple_g[i]) @ w_ple_gate[i])
        h = h + gate * (p[i] @ w_ple[i])
    return h
```

```cpp
#include <hip/hip_runtime.h>
#include <hip/hip_cooperative_groups.h>
namespace cg = cooperative_groups;

typedef unsigned short bf16_t;
typedef short s4 __attribute__((ext_vector_type(4)));
typedef float f4 __attribute__((ext_vector_type(4)));

#define NTH 256
#define EPSF 1e-6f
#define SEQ 16384
#define NTOK 32768

__device__ __forceinline__ unsigned f2b(float f) { unsigned u = __float_as_uint(f); u += 0x7fffu + ((u >> 16) & 1u); return u >> 16; }
__device__ __forceinline__ float b2f(unsigned b) { return __uint_as_float((b & 0xffffu) << 16); }
__device__ __forceinline__ float sigm(float x) { return 1.f / (1.f + __expf(-x)); }
__device__ __forceinline__ float silu(float x) { return x * sigm(x); }
__device__ __forceinline__ float wave_sum(float v) { for (int o = 32; o > 0; o >>= 1) v += __shfl_xor(v, o); return v; }

struct Prm {
  const float *x, *p, *pre_g, *post_g, *ple_g, *w_ple, *w_ple_gate, *e_w_in, *e_conv, *e_ln_g, *e_ln_b, *e_ws, *e_bs, *e_w_out,
      *o_w_in, *o_bif, *o_mhg, *o_w_out;
  float* out;
  char* ws;
};

template <int NSEG, bool AF32, bool BF32, bool TRANSB, bool TRIL, class Epi>
__device__ __forceinline__ void gemm_tile(const void* Ap, long lda, const void* Bp, long ldb, int K, int c0, int c1, int c2, int c3,
                                          int colmax, bf16_t* As, bf16_t* Bs, Epi epi) {
  const int tid = threadIdx.x, lane = tid & 63, w = tid >> 6, l16 = lane & 15, lq = lane >> 4;
  f4 acc[2][NSEG * 2];
#pragma unroll
  for (int a = 0; a < 2; a++)
#pragma unroll
    for (int b = 0; b < NSEG * 2; b++) acc[a][b] = (f4){0.f, 0.f, 0.f, 0.f};
  for (int k0 = 0; k0 < K; k0 += 32) {
    __syncthreads();
#pragma unroll
    for (int i = 0; i < 4; i++) {
      int g = tid + 256 * i;
      int m = g >> 3, kg = g & 7;
      uint2 pk;
      if (AF32) {
        float4 f = *(const float4*)((const float*)Ap + (long)m * lda + k0 + kg * 4);
        if (TRIL) {
          int kk = k0 + kg * 4;
          if (kk > m) f.x = 0.f;
          if (kk + 1 > m) f.y = 0.f;
          if (kk + 2 > m) f.z = 0.f;
          if (kk + 3 > m) f.w = 0.f;
        }
        pk.x = f2b(f.x) | (f2b(f.y) << 16);
        pk.y = f2b(f.z) | (f2b(f.w) << 16);
      } else {
        pk = *(const uint2*)((const bf16_t*)Ap + (long)m * lda + k0 + kg * 4);
      }
      *(uint2*)(As + m * 36 + kg * 4) = pk;
    }
#pragma unroll
    for (int i = 0; i < NSEG; i++) {
      int g = tid + 256 * i;
      if (TRANSB) {
        int n = g >> 3, kg = g & 7;
        int sg = n >> 5;
        int col = (sg == 0 ? c0 : sg == 1 ? c1 : sg == 2 ? c2 : c3) + (n & 31);
        uint2 pk = *(const uint2*)((const bf16_t*)Bp + (long)col * ldb + k0 + kg * 4);
        *(uint2*)(Bs + n * 36 + kg * 4) = pk;
      } else {
        int n = g % (NSEG * 32), kg = g / (NSEG * 32);
        int sg = n >> 5;
        int col = (sg == 0 ? c0 : sg == 1 ? c1 : sg == 2 ? c2 : c3) + (n & 31);
        col = col < colmax ? col : colmax;
        long kb = k0 + kg * 4;
        unsigned e0, e1, e2, e3;
        if (BF32) {
          const float* bp = (const float*)Bp + kb * ldb + col;
          e0 = f2b(bp[0]); e1 = f2b(bp[ldb]); e2 = f2b(bp[2 * ldb]); e3 = f2b(bp[3 * ldb]);
        } else {
          const bf16_t* bp = (const bf16_t*)Bp + kb * ldb + col;
          e0 = bp[0]; e1 = bp[ldb]; e2 = bp[2 * ldb]; e3 = bp[3 * ldb];
        }
        uint2 pk;
        pk.x = e0 | (e1 << 16);
        pk.y = e2 | (e3 << 16);
        *(uint2*)(Bs + n * 36 + kg * 4) = pk;
      }
    }
    __syncthreads();
#pragma unroll
    for (int ks = 0; ks < 2; ks++) {
      s4 a0 = *(const s4*)(As + (w * 32 + l16) * 36 + ks * 16 + lq * 4);
      s4 a1 = *(const s4*)(As + (w * 32 + 16 + l16) * 36 + ks * 16 + lq * 4);
#pragma unroll
      for (int nb = 0; nb < NSEG * 2; nb++) {
        s4 b = *(const s4*)(Bs + (nb * 16 + l16) * 36 + ks * 16 + lq * 4);
        acc[0][nb] = __builtin_amdgcn_mfma_f32_16x16x16bf16_1k(a0, b, acc[0][nb], 0, 0, 0);
        acc[1][nb] = __builtin_amdgcn_mfma_f32_16x16x16bf16_1k(a1, b, acc[1][nb], 0, 0, 0);
      }
    }
  }
#pragma unroll
  for (int mb = 0; mb < 2; mb++)
#pragma unroll
    for (int j = 0; j < 4; j++)
#pragma unroll
      for (int h = 0; h < 2; h++) {
        int row = w * 32 + mb * 16 + lq * 4 + j;
        int cj = h * 16 + l16;
        float v0 = acc[mb][h][j];
        float v1 = NSEG > 1 ? acc[mb][(NSEG > 1 ? 2 : 0) + h][j] : 0.f;
        float v2 = NSEG > 2 ? acc[mb][(NSEG > 2 ? 4 : 0) + h][j] : 0.f;
        float v3 = NSEG > 3 ? acc[mb][(NSEG > 3 ? 6 : 0) + h][j] : 0.f;
        epi(row, cj, v0, v1, v2, v3);
      }
}

__device__ void ph_rmsnorm(const float* src, const float* g, bf16_t* dst, int rows) {
  int lane = threadIdx.x & 63;
  int wid = (blockIdx.x * NTH + threadIdx.x) >> 6, nw = (gridDim.x * NTH) >> 6;
  for (int r = wid; r < rows; r += nw) {
    const float4* sp = (const float4*)(src + (long)r * 1024);
    float4 v0 = sp[lane], v1 = sp[lane + 64], v2 = sp[lane + 128], v3 = sp[lane + 192];
    float ss = v0.x * v0.x + v0.y * v0.y + v0.z * v0.z + v0.w * v0.w + v1.x * v1.x + v1.y * v1.y + v1.z * v1.z + v1.w * v1.w +
               v2.x * v2.x + v2.y * v2.y + v2.z * v2.z + v2.w * v2.w + v3.x * v3.x + v3.y * v3.y + v3.z * v3.z + v3.w * v3.w;
    ss = wave_sum(ss);
    float rs = rsqrtf(ss * (1.f / 1024.f) + EPSF);
    const float4* gp = (const float4*)g;
    uint2* dp = (uint2*)(dst + (long)r * 1024);
    float4 gg;
    uint2 o;
    gg = gp[lane];       o.x = f2b(v0.x * rs * gg.x) | (f2b(v0.y * rs * gg.y) << 16); o.y = f2b(v0.z * rs * gg.z) | (f2b(v0.w * rs * gg.w) << 16); dp[lane] = o;
    gg = gp[lane + 64];  o.x = f2b(v1.x * rs * gg.x) | (f2b(v1.y * rs * gg.y) << 16); o.y = f2b(v1.z * rs * gg.z) | (f2b(v1.w * rs * gg.w) << 16); dp[lane + 64] = o;
    gg = gp[lane + 128]; o.x = f2b(v2.x * rs * gg.x) | (f2b(v2.y * rs * gg.y) << 16); o.y = f2b(v2.z * rs * gg.z) | (f2b(v2.w * rs * gg.w) << 16); dp[lane + 128] = o;
    gg = gp[lane + 192]; o.x = f2b(v3.x * rs * gg.x) | (f2b(v3.y * rs * gg.y) << 16); o.y = f2b(v3.z * rs * gg.z) | (f2b(v3.w * rs * gg.w) << 16); dp[lane + 192] = o;
  }
}

__device__ void ph_post(const float* hsrc, const float* YP, const float* post_g, const float* ple_g, float* out, bf16_t* hn) {
  int lane = threadIdx.x & 63;
  int wid = (blockIdx.x * NTH + threadIdx.x) >> 6, nw = (gridDim.x * NTH) >> 6;
  for (int r = wid; r < NTOK; r += nw) {
    const float* yp = YP + (long)r * 1024;
    const float* hp = hsrc + (long)r * 1024;
    float ss = 0.f;
    for (int i = 0; i < 16; i++) { float y = yp[lane + 64 * i]; ss += y * y; }
    ss = wave_sum(ss);
    float rs = rsqrtf(ss * (1.f / 1024.f) + EPSF);
    float s2 = 0.f;
    for (int i = 0; i < 16; i++) {
      int c = lane + 64 * i;
      float hm = hp[c] + yp[c] * rs * post_g[c];
      out[(long)r * 1024 + c] = hm;
      s2 += hm * hm;
    }
    s2 = wave_sum(s2);
    float r2 = rsqrtf(s2 * (1.f / 1024.f) + EPSF);
    for (int i = 0; i < 16; i++) {
      int c = lane + 64 * i;
      float hm = out[(long)r * 1024 + c];
      hn[(long)r * 1024 + c] = (bf16_t)f2b(hm * r2 * ple_g[c]);
    }
  }
}

__global__ void __launch_bounds__(NTH) mega(Prm P) {
  cg::grid_group grid = cg::this_grid();
  __shared__ __attribute__((aligned(16))) bf16_t As[128 * 36];
  __shared__ __attribute__((aligned(16))) bf16_t Bs[128 * 36];
  const int tid = threadIdx.x;
  const int gtid = blockIdx.x * NTH + tid, gsz = gridDim.x * NTH;
  const int BIGC = 1 << 30;

  char* ws = P.ws;
  bf16_t* R1 = (bf16_t*)ws;
  bf16_t* Y = (bf16_t*)(ws + 67108864L);
  float* PE = (float*)(ws + 67108864L);
  char* R3 = ws + 201326592L;
  float* YP = (float*)R3;
  bf16_t* U = (bf16_t*)R3;
  bf16_t* V = (bf16_t*)(R3 + 67108864L);
  bf16_t* Qb = (bf16_t*)R3;
  bf16_t* Kb = (bf16_t*)(R3 + 33554432L);
  bf16_t* Vb = (bf16_t*)(R3 + 67108864L);
  char* R4 = ws + 335544320L;
  bf16_t* QC = (bf16_t*)R4;
  bf16_t* Pm = (bf16_t*)(R4 + 67108864L);
  float* sm = (float*)(R4 + 67108864L + 33554432L);
  float* GATE = sm;
  float* Bc = GATE + 16384 * 16;
  float* IP = Bc + 16384 * 8;
  float* Mloc = IP + 16384 * 8;
  float* Aar = Mloc + 16384 * 8;
  float* QN = Aar + 16384 * 8;
  float* ISC = QN + 16384 * 8;
  float* RDN = ISC + 16384 * 8;
  float* Gc = RDN + 16384 * 8;
  float* AMX = Gc + 1024;
  float* MALL = AMX + 1024;
  float* Cst = MALL + 1024;
  float* Nst = Cst + 2 * 262144;
  float* Mst = Nst + 2 * 1024;

  for (int layer = 0; layer < 4; layer++) {
    const int lj = layer >> 1;
    const float* hsrc = layer == 0 ? P.x : P.out;
    ph_rmsnorm(hsrc, P.pre_g + layer * 1024, R1, NTOK);
    grid.sync();
    const float* w_out;
    if ((layer & 1) == 0) {
      const float* w_in = P.e_w_in + (long)lj * 1024 * 7168;
      w_out = P.e_w_out + (long)lj * 2048 * 1024;
      for (int t = blockIdx.x; t < 256 * 64; t += gridDim.x) {
        int rt = t >> 6, ct = t & 63;
        const bf16_t* Ap = R1 + (long)rt * 128 * 1024;
        long r0 = (long)rt * 128;
        if (ct < 32) {
          int j0 = ct * 32;
          gemm_tile<4, false, true, false, false>(Ap, 1024, w_in, 7168, 1024, j0, 1024 + j0, 2048 + j0, 3072 + j0, BIGC, As, Bs,
            [&](int row, int cj, float v0, float v1, float v2, float v3) {
              long r = r0 + row; int j = j0 + cj;
              U[r * 1024 + j] = (bf16_t)f2b(v1 * v2);
              Y[r * 2048 + j] = (bf16_t)f2b(v0 * silu(v3));
            });
        } else {
          int j0 = (ct - 32) * 32;
          gemm_tile<3, false, true, false, false>(Ap, 1024, w_in, 7168, 1024, 4096 + j0, 5120 + j0, 6144 + j0, 0, BIGC, As, Bs,
            [&](int row, int cj, float v0, float v1, float v2, float v3) {
              long r = r0 + row; int j = j0 + cj;
              V[r * 1024 + j] = (bf16_t)f2b(v1);
              Y[r * 2048 + 1024 + j] = (bf16_t)f2b(v0 * silu(v2));
            });
        }
      }
      grid.sync();
      {
        const float* lg = P.e_ln_g + lj * 1024; const float* lb = P.e_ln_b + lj * 1024;
        const float* cw = P.e_conv + lj * 3 * 1024;
        int lane = tid & 63; int wid = gtid >> 6, nw = gsz >> 6;
        for (int r = wid; r < NTOK; r += nw) {
          bf16_t* vp = V + (long)r * 1024;
          float s = 0.f;
          for (int i = 0; i < 16; i++) s += b2f(vp[lane + 64 * i]);
          s = wave_sum(s);
          float mu = s * (1.f / 1024.f);
          float q = 0.f;
          for (int i = 0; i < 16; i++) { float d = b2f(vp[lane + 64 * i]) - mu; q += d * d; }
          q = wave_sum(q);
          float rs = rsqrtf(q * (1.f / 1024.f) + EPSF);
          int tt = r & (SEQ - 1);
          for (int i = 0; i < 16; i++) {
            int c = lane + 64 * i;
            float d = (b2f(vp[c]) - mu) * rs * lg[c] + lb[c];
            vp[c] = (bf16_t)f2b(d);
            float cv = cw[2048 + c] * b2f(U[(long)r * 1024 + c]);
            if (tt >= 1) cv += cw[1024 + c] * b2f(U[(long)(r - 1) * 1024 + c]);
            if (tt >= 2) cv += cw[c] * b2f(U[(long)(r - 2) * 1024 + c]);
            bf16_t* yp = Y + (long)r * 2048 + c;
            *yp = (bf16_t)f2b(b2f(*yp) * cv);
          }
        }
      }
      grid.sync();
      for (int t = blockIdx.x; t < 256 * 8; t += gridDim.x) {
        int ch = t >> 3, g = t & 7;
        const float* Ap = P.e_ws + (long)lj * 8 * 16384 + (long)g * 16384;
        const bf16_t* Bp = V + (long)ch * 128 * 1024 + g * 128;
        const float* bs = P.e_bs + lj * 1024;
        gemm_tile<4, true, false, false, true>(Ap, 128, Bp, 1024, 128, 0, 32, 64, 96, BIGC, As, Bs,
          [&](int row, int cj, float v0, float v1, float v2, float v3) {
            float b = bs[row * 8 + g];
            bf16_t* yp = Y + ((long)ch * 128 + row) * 2048 + 1024 + g * 128 + cj;
            yp[0] = (bf16_t)f2b(b2f(yp[0]) * (v0 + b));
            yp[32] = (bf16_t)f2b(b2f(yp[32]) * (v1 + b));
            yp[64] = (bf16_t)f2b(b2f(yp[64]) * (v2 + b));
            yp[96] = (bf16_t)f2b(b2f(yp[96]) * (v3 + b));
          });
      }
      grid.sync();
    } else {
      const float* w_in = P.o_w_in + (long)lj * 1024 * 8208;
      w_out = P.o_w_out + (long)lj * 2048 * 1024;
      const float* bif = P.o_bif + lj * 16;
      const float* mhg = P.o_mhg + lj * 2048;
      for (int bb = 0; bb < 2; bb++) {
        const long tok0 = (long)bb * SEQ;
        for (int t = blockIdx.x; t < 128 * 65; t += gridDim.x) {
          int rt = t / 65, ct = t % 65;
          const bf16_t* Ap = R1 + (tok0 + (long)rt * 128) * 1024;
          long r0 = (long)rt * 128;
          if (ct < 8) {
            int j0 = ct * 128;
            gemm_tile<4, false, true, false, false>(Ap, 1024, w_in, 8208, 1024, j0, j0 + 32, j0 + 64, j0 + 96, BIGC, As, Bs,
              [&](int row, int cj, float v0, float v1, float v2, float v3) {
                bf16_t* q = Qb + (r0 + row) * 1024 + j0 + cj;
                const float sc = 0.08838834764831845f;
                q[0] = (bf16_t)f2b(v0 * sc); q[32] = (bf16_t)f2b(v1 * sc); q[64] = (bf16_t)f2b(v2 * sc); q[96] = (bf16_t)f2b(v3 * sc);
              });
          } else if (ct < 16) {
            int j0 = (ct - 8) * 128;
            gemm_tile<4, false, true, false, false>(Ap, 1024, w_in, 8208, 1024, 1024 + j0, 1024 + j0 + 32, 1024 + j0 + 64, 1024 + j0 + 96, BIGC, As, Bs,
              [&](int row, int cj, float v0, float v1, float v2, float v3) {
                bf16_t* q = Kb + (r0 + row) * 1024 + j0 + cj;
                q[0] = (bf16_t)f2b(v0); q[32] = (bf16_t)f2b(v1); q[64] = (bf16_t)f2b(v2); q[96] = (bf16_t)f2b(v3);
              });
          } else if (ct < 32) {
            int j0 = (ct - 16) * 128;
            gemm_tile<4, false, true, false, false>(Ap, 1024, w_in, 8208, 1024, 2048 + j0, 2048 + j0 + 32, 2048 + j0 + 64, 2048 + j0 + 96, BIGC, As, Bs,
              [&](int row, int cj, float v0, float v1, float v2, float v3) {
                bf16_t* q = Vb + (r0 + row) * 2048 + j0 + cj;
                q[0] = (bf16_t)f2b(v0); q[32] = (bf16_t)f2b(v1); q[64] = (bf16_t)f2b(v2); q[96] = (bf16_t)f2b(v3);
              });
          } else if (ct < 64) {
            int j0 = (ct - 32) * 64;
            gemm_tile<4, false, true, false, false>(Ap, 1024, w_in, 8208, 1024, 4096 + j0, 4096 + j0 + 32, 6144 + j0, 6144 + j0 + 32, BIGC, As, Bs,
              [&](int row, int cj, float v0, float v1, float v2, float v3) {
                bf16_t* q = Y + (tok0 + r0 + row) * 2048 + j0 + cj;
                q[0] = (bf16_t)f2b(sigm(v0) * silu(v2));
                q[32] = (bf16_t)f2b(sigm(v1) * silu(v3));
              });
          } else {
            gemm_tile<1, false, true, false, false>(Ap, 1024, w_in, 8208, 1024, 8192, 0, 0, 0, 8207, As, Bs,
              [&](int row, int cj, float v0, float v1, float v2, float v3) {
                if (cj < 16) GATE[(r0 + row) * 16 + cj] = v0 + bif[cj];
              });
          }
        }
        grid.sync();
        for (int it = gtid; it < 1024; it += gsz) {
          int n = it >> 3, h = it & 7;
          float b = 0.f, pm = -INFINITY;
          for (int s = 0; s < 128; s++) {
            long tk = (long)n * 128 + s;
            float ip = GATE[tk * 16 + h], fp = GATE[tk * 16 + 8 + h];
            float lf = fminf(fp, 0.f) - log1pf(__expf(-fabsf(fp)));
            b += lf;
            pm = fmaxf(pm, ip - b);
            Bc[tk * 8 + h] = b; IP[tk * 8 + h] = ip; Mloc[tk * 8 + h] = b + pm;
          }
          float g = b, am = -INFINITY;
          for (int s = 0; s < 128; s++) {
            long tk = (long)n * 128 + s;
            float a = g - Bc[tk * 8 + h] + IP[tk * 8 + h];
            Aar[tk * 8 + h] = a;
            am = fmaxf(am, a);
          }
          Gc[it] = g; AMX[it] = am;
        }
        for (int it = gtid; it < 262144; it += gsz) Cst[it] = 0.f;
        for (int it = gtid; it < 1024; it += gsz) Nst[it] = 0.f;
        if (gtid < 8) Mst[gtid] = 0.f;
        grid.sync();
        for (int n = 0; n < 128; n++) {
          const int cur = n & 1, nxt = cur ^ 1;
          const float* Cc = Cst + cur * 262144; float* Cn = Cst + nxt * 262144;
          const float* Nc = Nst + cur * 1024; float* Nn = Nst + nxt * 1024;
          for (int it = gtid; it < 262144; it += gsz) {
            int v = it & 255, r = (it >> 8) & 127, h = it >> 15;
            float m_old = Mst[cur * 8 + h];
            float gg = Gc[n * 8 + h], am = AMX[n * 8 + h];
            float m_new = fmaxf(gg + m_old, am);
            float decay = __expf(gg + m_old - m_new);
            const bf16_t* qp = Qb + ((long)n * 128 + r) * 1024 + h * 128;
            const float* cp = Cc + h * 32768 + v;
            float a1 = 0.f;
            for (int kd = 0; kd < 128; kd++) a1 += b2f(qp[kd]) * cp[kd * 256];
            const bf16_t* kp = Kb + ((long)n * 128) * 1024 + h * 128 + r;
            const bf16_t* vp = Vb + ((long)n * 128) * 2048 + h * 256 + v;
            const float* ap = Aar + ((long)n * 128) * 8 + h;
            float a2 = 0.f;
            for (int s = 0; s < 128; s++) a2 += b2f(kp[s * 1024]) * __expf(ap[s * 8] - m_new) * b2f(vp[s * 2048]);
            Cn[h * 32768 + r * 256 + v] = decay * Cc[h * 32768 + r * 256 + v] + a2;
            QC[((long)n * 128 + r) * 2048 + h * 256 + v] = (bf16_t)f2b(a1);
            if (v == 0) {
              float qn = 0.f;
              for (int kd = 0; kd < 128; kd++) qn += b2f(qp[kd]) * Nc[h * 128 + kd];
              QN[((long)n * 128 + r) * 8 + h] = qn;
              float kn = 0.f;
              for (int s = 0; s < 128; s++) kn += b2f(kp[s * 1024]) * __expf(ap[s * 8] - m_new);
              Nn[h * 128 + r] = decay * Nc[h * 128 + r] + kn;
              if (r == 0) { MALL[n * 8 + h] = m_old; Mst[nxt * 8 + h] = m_new; }
            }
          }
          grid.sync();
        }
        for (int t = blockIdx.x; t < 1024; t += gridDim.x) {
          int n = t >> 3, h = t & 7;
          const bf16_t* Ap = Qb + (long)n * 128 * 1024 + h * 128;
          const bf16_t* Bp = Kb + (long)n * 128 * 1024 + h * 128;
          float mall = MALL[t];
          gemm_tile<4, false, false, true, false>(Ap, 1024, Bp, 1024, 128, 0, 32, 64, 96, BIGC, As, Bs,
            [&](int row, int cj, float v0, float v1, float v2, float v3) {
              long tk = (long)n * 128 + row;
              float bt = Bc[tk * 8 + h];
              float mt = fmaxf(bt + mall, Mloc[tk * 8 + h]);
              bf16_t* pp = Pm + ((long)t * 128 + row) * 128 + cj;
              float vv[4] = {v0, v1, v2, v3};
#pragma unroll
              for (int q = 0; q < 4; q++) {
                int s = cj + 32 * q;
                float pv = 0.f;
                if (s <= row) {
                  long ts = (long)n * 128 + s;
                  pv = __expf(bt - Bc[ts * 8 + h] + IP[ts * 8 + h] - mt) * vv[q];
                }
                pp[32 * q] = (bf16_t)f2b(pv);
              }
            });
        }
        grid.sync();
        for (int it = gtid; it < 131072; it += gsz) {
          int row = it & 127, h = (it >> 7) & 7, n = it >> 10;
          long tk = (long)n * 128 + row;
          const bf16_t* pp = Pm + ((long)(n * 8 + h) * 128 + row) * 128;
          float rsum = 0.f;
          for (int s = 0; s < 128; s++) rsum += b2f(pp[s]);
          float mi = Bc[tk * 8 + h] + MALL[n * 8 + h];
          float mt = fmaxf(mi, Mloc[tk * 8 + h]);
          float isc = __expf(mi - mt);
          float den = isc * QN[tk * 8 + h] + rsum;
          float dn = fmaxf(fabsf(den), __expf(-mt));
          ISC[tk * 8 + h] = isc / dn; RDN[tk * 8 + h] = 1.f / dn;
        }
        grid.sync();
        for (int t = blockIdx.x; t < 2048; t += gridDim.x) {
          int half = t & 1, nh = t >> 1, n = nh >> 3, h = nh & 7;
          const bf16_t* Ap = Pm + (long)nh * 128 * 128;
          const bf16_t* Bp = Vb + (long)n * 128 * 2048 + h * 256 + half * 128;
          gemm_tile<4, false, false, false, false>(Ap, 128, Bp, 2048, 128, 0, 32, 64, 96, BIGC, As, Bs,
            [&](int row, int cj, float v0, float v1, float v2, float v3) {
              long tk = (long)n * 128 + row;
              float isc = ISC[tk * 8 + h], rdn = RDN[tk * 8 + h];
              bf16_t* qp = QC + tk * 2048 + h * 256 + half * 128 + cj;
              qp[0] = (bf16_t)f2b(isc * b2f(qp[0]) + rdn * v0);
              qp[32] = (bf16_t)f2b(isc * b2f(qp[32]) + rdn * v1);
              qp[64] = (bf16_t)f2b(isc * b2f(qp[64]) + rdn * v2);
              qp[96] = (bf16_t)f2b(isc * b2f(qp[96]) + rdn * v3);
            });
        }
        grid.sync();
        {
          int lane = tid & 63; int wid = gtid >> 6, nw = gsz >> 6;
          for (int it = wid; it < SEQ * 8; it += nw) {
            int h = it & 7; long tk = it >> 3;
            const bf16_t* hp = QC + tk * 2048 + h * 256;
            float x0 = b2f(hp[lane]), x1 = b2f(hp[lane + 64]), x2 = b2f(hp[lane + 128]), x3 = b2f(hp[lane + 192]);
            float ss = wave_sum(x0 * x0 + x1 * x1 + x2 * x2 + x3 * x3);
            float rs = rsqrtf(ss * (1.f / 256.f) + EPSF);
            bf16_t* yp = Y + (tok0 + tk) * 2048 + h * 256;
            const float* gp = mhg + h * 256;
            yp[lane] = (bf16_t)f2b(b2f(yp[lane]) * x0 * rs * gp[lane]);
            yp[lane + 64] = (bf16_t)f2b(b2f(yp[lane + 64]) * x1 * rs * gp[lane + 64]);
            yp[lane + 128] = (bf16_t)f2b(b2f(yp[lane + 128]) * x2 * rs * gp[lane + 128]);
            yp[lane + 192] = (bf16_t)f2b(b2f(yp[lane + 192]) * x3 * rs * gp[lane + 192]);
          }
        }
        grid.sync();
      }
    }
    for (int t = blockIdx.x; t < 256 * 8; t += gridDim.x) {
      int rt = t >> 3, ct = t & 7;
      int j0 = ct * 128; long r0 = (long)rt * 128;
      gemm_tile<4, false, true, false, false>(Y + r0 * 2048, 2048, w_out, 1024, 2048, j0, j0 + 32, j0 + 64, j0 + 96, BIGC, As, Bs,
        [&](int row, int cj, float v0, float v1, float v2, float v3) {
          float* yp = YP + (r0 + row) * 1024 + j0 + cj;
          yp[0] = v0; yp[32] = v1; yp[64] = v2; yp[96] = v3;
        });
    }
    grid.sync();
    ph_post(hsrc, YP, P.post_g + layer * 1024, P.ple_g + layer * 1024, P.out, R1);
    for (int t = blockIdx.x; t < 256 * 8; t += gridDim.x) {
      int rt = t >> 3, ct = t & 7;
      int j0 = ct * 128; long r0 = (long)rt * 128;
      gemm_tile<4, true, true, false, false>(P.p + ((long)layer * NTOK + r0) * 256, 256, P.w_ple + (long)layer * 256 * 1024, 1024, 256,
        j0, j0 + 32, j0 + 64, j0 + 96, BIGC, As, Bs,
        [&](int row, int cj, float v0, float v1, float v2, float v3) {
          float* yp = PE + (r0 + row) * 1024 + j0 + cj;
          yp[0] = v0; yp[32] = v1; yp[64] = v2; yp[96] = v3;
        });
    }
    grid.sync();
    for (int t = blockIdx.x; t < 256 * 8; t += gridDim.x) {
      int rt = t >> 3, ct = t & 7;
      int j0 = ct * 128; long r0 = (long)rt * 128;
      gemm_tile<4, false, true, false, false>(R1 + r0 * 1024, 1024, P.w_ple_gate + (long)layer * 1024 * 1024, 1024, 1024,
        j0, j0 + 32, j0 + 64, j0 + 96, BIGC, As, Bs,
        [&](int row, int cj, float v0, float v1, float v2, float v3) {
          long o = (r0 + row) * 1024 + j0 + cj;
          P.out[o] += sigm(v0) * PE[o];
          P.out[o + 32] += sigm(v1) * PE[o + 32];
          P.out[o + 64] += sigm(v2) * PE[o + 64];
          P.out[o + 96] += sigm(v3) * PE[o + 96];
        });
    }
    grid.sync();
  }
}

extern "C" void kernel_launch(void* const* d_in, const int* in_sizes, int n_in, void* d_out, int out_size, void* d_ws, size_t ws_size,
                              hipStream_t stream) {
  Prm P;
  P.x = (const float*)d_in[0]; P.p = (const float*)d_in[1]; P.pre_g = (const float*)d_in[2]; P.post_g = (const float*)d_in[3];
  P.ple_g = (const float*)d_in[4]; P.w_ple = (const float*)d_in[5]; P.w_ple_gate = (const float*)d_in[6]; P.e_w_in = (const float*)d_in[7];
  P.e_conv = (const float*)d_in[8]; P.e_ln_g = (const float*)d_in[9]; P.e_ln_b = (const float*)d_in[10]; P.e_ws = (const float*)d_in[11];
  P.e_bs = (const float*)d_in[12]; P.e_w_out = (const float*)d_in[13]; P.o_w_in = (const float*)d_in[14]; P.o_bif = (const float*)d_in[15];
  P.o_mhg = (const float*)d_in[16]; P.o_w_out = (const float*)d_in[17];
  P.out = (float*)d_out; P.ws = (char*)d_ws;
  int dev = 0; hipGetDevice(&dev);
  hipDeviceProp_t prop; hipGetDeviceProperties(&prop, dev);
  int occ = 0;
  hipOccupancyMaxActiveBlocksPerMultiprocessor(&occ, (const void*)mega, NTH, 0);
  if (occ < 1) occ = 1;
  if (occ > 4) occ = 4;
  int nblk = occ * prop.multiProcessorCount;
  void* args[] = {&P};
  hipLaunchCooperativeKernel((const void*)mega, dim3(nblk), dim3(NTH), args, 0, stream);
}
```

```cpp
#include <hip/hip_runtime.h>
#include <hip/hip_cooperative_groups.h>
namespace cg = cooperative_groups;

typedef unsigned short bf16_t;
typedef short s4 __attribute__((ext_vector_type(4)));
typedef float f4 __attribute__((ext_vector_type(4)));

#define NTH 256
#define EPSF 1e-6f
#define SEQ 16384
#define NTOK 32768

__device__ __forceinline__ unsigned f2b(float f) { unsigned u = __float_as_uint(f); u += 0x7fffu + ((u >> 16) & 1u); return u >> 16; }
__device__ __forceinline__ float b2f(unsigned b) { return __uint_as_float((b & 0xffffu) << 16); }
__device__ __forceinline__ float sigm(float x) { return 1.f / (1.f + __expf(-x)); }
__device__ __forceinline__ float silu(float x) { return x * sigm(x); }
__device__ __forceinline__ float wave_sum(float v) { for (int o = 32; o > 0; o >>= 1) v += __shfl_xor(v, o); return v; }

struct Prm {
  const float *x, *p, *pre_g, *post_g, *ple_g, *w_ple, *w_ple_gate, *e_w_in, *e_conv, *e_ln_g, *e_ln_b, *e_ws, *e_bs, *e_w_out,
      *o_w_in, *o_bif, *o_mhg, *o_w_out;
  float* out;
  char* ws;
};

template <int NSEG, bool AF32, bool BF32, bool TRANSB, bool TRIL, class Epi>
__device__ __forceinline__ void gemm_tile(const void* Ap, long lda, const void* Bp, long ldb, int K, int c0, int c1, int c2, int c3,
                                          int colmax, bf16_t* As, bf16_t* Bs, Epi epi) {
  const int tid = threadIdx.x, lane = tid & 63, w = tid >> 6, l16 = lane & 15, lq = lane >> 4;
  f4 acc[2][NSEG * 2];
#pragma unroll
  for (int a = 0; a < 2; a++)
#pragma unroll
    for (int b = 0; b < NSEG * 2; b++) acc[a][b] = (f4){0.f, 0.f, 0.f, 0.f};
  for (int k0 = 0; k0 < K; k0 += 32) {
    __syncthreads();
#pragma unroll
    for (int i = 0; i < 4; i++) {
      int g = tid + 256 * i;
      int m = g >> 3, kg = g & 7;
      uint2 pk;
      if (AF32) {
        float4 f = *(const float4*)((const float*)Ap + (long)m * lda + k0 + kg * 4);
        if (TRIL) {
          int kk = k0 + kg * 4;
          if (kk > m) f.x = 0.f;
          if (kk + 1 > m) f.y = 0.f;
          if (kk + 2 > m) f.z = 0.f;
          if (kk + 3 > m) f.w = 0.f;
        }
        pk.x = f2b(f.x) | (f2b(f.y) << 16);
        pk.y = f2b(f.z) | (f2b(f.w) << 16);
      } else {
        pk = *(const uint2*)((const bf16_t*)Ap + (long)m * lda + k0 + kg * 4);
      }
      *(uint2*)(As + m * 36 + kg * 4) = pk;
    }
#pragma unroll
    for (int i = 0; i < NSEG; i++) {
      int g = tid + 256 * i;
      if (TRANSB) {
        int n = g >> 3, kg = g & 7;
        int sg = n >> 5;
        int col = (sg == 0 ? c0 : sg == 1 ? c1 : sg == 2 ? c2 : c3) + (n & 31);
        uint2 pk = *(const uint2*)((const bf16_t*)Bp + (long)col * ldb + k0 + kg * 4);
        *(uint2*)(Bs + n * 36 + kg * 4) = pk;
      } else {
        int n = g % (NSEG * 32), kg = g / (NSEG * 32);
        int sg = n >> 5;
        int col = (sg == 0 ? c0 : sg == 1 ? c1 : sg == 2 ? c2 : c3) + (n & 31);
        col = col < colmax ? col : colmax;
        long kb = k0 + kg * 4;
        unsigned e0, e1, e2, e3;
        if (BF32) {
          const float* bp = (const float*)Bp + kb * ldb + col;
          e0 = f2b(bp[0]); e1 = f2b(bp[ldb]); e2 = f2b(bp[2 * ldb]); e3 = f2b(bp[3 * ldb]);
        } else {
          const bf16_t* bp = (const bf16_t*)Bp + kb * ldb + col;
          e0 = bp[0]; e1 = bp[ldb]; e2 = bp[2 * ldb]; e3 = bp[3 * ldb];
        }
        uint2 pk;
        pk.x = e0 | (e1 << 16);
        pk.y = e2 | (e3 << 16);
        *(uint2*)(Bs + n * 36 + kg * 4) = pk;
      }
    }
    __syncthreads();
#pragma unroll
    for (int ks = 0; ks < 2; ks++) {
      s4 a0 = *(const s4*)(As + (w * 32 + l16) * 36 + ks * 16 + lq * 4);
      s4 a1 = *(const s4*)(As + (w * 32 + 16 + l16) * 36 + ks * 16 + lq * 4);
#pragma unroll
      for (int nb = 0; nb < NSEG * 2; nb++) {
        s4 b = *(const s4*)(Bs + (nb * 16 + l16) * 36 + ks * 16 + lq * 4);
        acc[0][nb] = __builtin_amdgcn_mfma_f32_16x16x16bf16_1k(a0, b, acc[0][nb], 0, 0, 0);
        acc[1][nb] = __builtin_amdgcn_mfma_f32_16x16x16bf16_1k(a1, b, acc[1][nb], 0, 0, 0);
      }
    }
  }
#pragma unroll
  for (int mb = 0; mb < 2; mb++)
#pragma unroll
    for (int j = 0; j < 4; j++)
#pragma unroll
      for (int h = 0; h < 2; h++) {
        int row = w * 32 + mb * 16 + lq * 4 + j;
        int cj = h * 16 + l16;
        float v0 = acc[mb][h][j];
        float v1 = NSEG > 1 ? acc[mb][(NSEG > 1 ? 2 : 0) + h][j] : 0.f;
        float v2 = NSEG > 2 ? acc[mb][(NSEG > 2 ? 4 : 0) + h][j] : 0.f;
        float v3 = NSEG > 3 ? acc[mb][(NSEG > 3 ? 6 : 0) + h][j] : 0.f;
        epi(row, cj, v0, v1, v2, v3);
      }
}

__device__ void ph_rmsnorm(const float* src, const float* g, bf16_t* dst, int rows) {
  int lane = threadIdx.x & 63;
  int wid = (blockIdx.x * NTH + threadIdx.x) >> 6, nw = (gridDim.x * NTH) >> 6;
  for (int r = wid; r < rows; r += nw) {
    const float4* sp = (const float4*)(src + (long)r * 1024);
    float4 v0 = sp[lane], v1 = sp[lane + 64], v2 = sp[lane + 128], v3 = sp[lane + 192];
    float ss = v0.x * v0.x + v0.y * v0.y + v0.z * v0.z + v0.w * v0.w + v1.x * v1.x + v1.y * v1.y + v1.z * v1.z + v1.w * v1.w +
               v2.x * v2.x + v2.y * v2.y + v2.z * v2.z + v2.w * v2.w + v3.x * v3.x + v3.y * v3.y + v3.z * v3.z + v3.w * v3.w;
    ss = wave_sum(ss);
    float rs = rsqrtf(ss * (1.f / 1024.f) + EPSF);
    const float4* gp = (const float4*)g;
    uint2* dp = (uint2*)(dst + (long)r * 1024);
    float4 gg;
    uint2 o;
    gg = gp[lane];       o.x = f2b(v0.x * rs * gg.x) | (f2b(v0.y * rs * gg.y) << 16); o.y = f2b(v0.z * rs * gg.z) | (f2b(v0.w * rs * gg.w) << 16); dp[lane] = o;
    gg = gp[lane + 64];  o.x = f2b(v1.x * rs * gg.x) | (f2b(v1.y * rs * gg.y) << 16); o.y = f2b(v1.z * rs * gg.z) | (f2b(v1.w * rs * gg.w) << 16); dp[lane + 64] = o;
    gg = gp[lane + 128]; o.x = f2b(v2.x * rs * gg.x) | (f2b(v2.y * rs * gg.y) << 16); o.y = f2b(v2.z * rs * gg.z) | (f2b(v2.w * rs * gg.w) << 16); dp[lane + 128] = o;
    gg = gp[lane + 192]; o.x = f2b(v3.x * rs * gg.x) | (f2b(v3.y * rs * gg.y) << 16); o.y = f2b(v3.z * rs * gg.z) | (f2b(v3.w * rs * gg.w) << 16); dp[lane + 192] = o;
  }
}

__device__ void ph_post(const float* hsrc, const float* YP, const float* post_g, const float* ple_g, float* out, bf16_t* hn) {
  int lane = threadIdx.x & 63;
  int wid = (blockIdx.x * NTH + threadIdx.x) >> 6, nw = (gridDim.x * NTH) >> 6;
  for (int r = wid; r < NTOK; r += nw) {
    const float* yp = YP + (long)r * 1024;
    const float* hp = hsrc + (long)r * 1024;
    float ss = 0.f;
    for (int i = 0; i < 16; i++) { float y = yp[lane + 64 * i]; ss += y * y; }
    ss = wave_sum(ss);
    float rs = rsqrtf(ss * (1.f / 1024.f) + EPSF);
    float s2 = 0.f;
    for (int i = 0; i < 16; i++) {
      int c = lane + 64 * i;
      float hm = hp[c] + yp[c] * rs * post_g[c];
      out[(long)r * 1024 + c] = hm;
      s2 += hm * hm;
    }
    s2 = wave_sum(s2);
    float r2 = rsqrtf(s2 * (1.f / 1024.f) + EPSF);
    for (int i = 0; i < 16; i++) {
      int c = lane + 64 * i;
      float hm = out[(long)r * 1024 + c];
      hn[(long)r * 1024 + c] = (bf16_t)f2b(hm * r2 * ple_g[c]);
    }
  }
}

__global__ void __launch_bounds__(NTH) mega(Prm P) {
  cg::grid_group grid = cg::this_grid();
  __shared__ __attribute__((aligned(16))) bf16_t As[128 * 36];
  __shared__ __attribute__((aligned(16))) bf16_t Bs[128 * 36];
  const int tid = threadIdx.x;
  const int gtid = blockIdx.x * NTH + tid, gsz = gridDim.x * NTH;
  const int BIGC = 1 << 30;

  char* ws = P.ws;
  bf16_t* R1 = (bf16_t*)ws;
  bf16_t* Y = (bf16_t*)(ws + 67108864L);
  float* PE = (float*)(ws + 67108864L);
  char* R3 = ws + 201326592L;
  float* YP = (float*)R3;
  bf16_t* U = (bf16_t*)R3;
  bf16_t* V = (bf16_t*)(R3 + 67108864L);
  bf16_t* Qb = (bf16_t*)R3;
  bf16_t* Kb = (bf16_t*)(R3 + 33554432L);
  bf16_t* Vb = (bf16_t*)(R3 + 67108864L);
  char* R4 = ws + 335544320L;
  bf16_t* QC = (bf16_t*)R4;
  bf16_t* Pm = (bf16_t*)(R4 + 67108864L);
  float* sm = (float*)(R4 + 67108864L + 33554432L);
  float* GATE = sm;
  float* Bc = GATE + 16384 * 16;
  float* IP = Bc + 16384 * 8;
  float* Mloc = IP + 16384 * 8;
  float* Aar = Mloc + 16384 * 8;
  float* QN = Aar + 16384 * 8;
  float* ISC = QN + 16384 * 8;
  float* RDN = ISC + 16384 * 8;
  float* Gc = RDN + 16384 * 8;
  float* AMX = Gc + 1024;
  float* MALL = AMX + 1024;
  float* Cst = MALL + 1024;
  float* Nst = Cst + 2 * 262144;
  float* Mst = Nst + 2 * 1024;

  for (int layer = 0; layer < 4; layer++) {
    const int lj = layer >> 1;
    const float* hsrc = layer == 0 ? P.x : P.out;
    ph_rmsnorm(hsrc, P.pre_g + layer * 1024, R1, NTOK);
    grid.sync();
    const float* w_out;
    if ((layer & 1) == 0) {
      const float* w_in = P.e_w_in + (long)lj * 1024 * 7168;
      w_out = P.e_w_out + (long)lj * 2048 * 1024;
      for (int t = blockIdx.x; t < 256 * 64; t += gridDim.x) {
        int rt = t >> 6, ct = t & 63;
        const bf16_t* Ap = R1 + (long)rt * 128 * 1024;
        long r0 = (long)rt * 128;
        if (ct < 32) {
          int j0 = ct * 32;
          gemm_tile<4, false, true, false, false>(Ap, 1024, w_in, 7168, 1024, j0, 1024 + j0, 2048 + j0, 3072 + j0, BIGC, As, Bs,
            [&](int row, int cj, float v0, float v1, float v2, float v3) {
              long r = r0 + row; int j = j0 + cj;
              U[r * 1024 + j] = (bf16_t)f2b(v1 * v2);
              Y[r * 2048 + j] = (bf16_t)f2b(v0 * silu(v3));
            });
        } else {
          int j0 = (ct - 32) * 32;
          gemm_tile<3, false, true, false, false>(Ap, 1024, w_in, 7168, 1024, 4096 + j0, 5120 + j0, 6144 + j0, 0, BIGC, As, Bs,
            [&](int row, int cj, float v0, float v1, float v2, float v3) {
              long r = r0 + row; int j = j0 + cj;
              V[r * 1024 + j] = (bf16_t)f2b(v1);
              Y[r * 2048 + 1024 + j] = (bf16_t)f2b(v0 * silu(v2));
            });
        }
      }
      grid.sync();
      {
        const float* lg = P.e_ln_g + lj * 1024; const float* lb = P.e_ln_b + lj * 1024;
        const float* cw = P.e_conv + lj * 3 * 1024;
        int lane = tid & 63; int wid = gtid >> 6, nw = gsz >> 6;
        for (int r = wid; r < NTOK; r += nw) {
          bf16_t* vp = V + (long)r * 1024;
          float s = 0.f;
          for (int i = 0; i < 16; i++) s += b2f(vp[lane + 64 * i]);
          s = wave_sum(s);
          float mu = s * (1.f / 1024.f);
          float q = 0.f;
          for (int i = 0; i < 16; i++) { float d = b2f(vp[lane + 64 * i]) - mu; q += d * d; }
          q = wave_sum(q);
          float rs = rsqrtf(q * (1.f / 1024.f) + EPSF);
          int tt = r & (SEQ - 1);
          for (int i = 0; i < 16; i++) {
            int c = lane + 64 * i;
            float d = (b2f(vp[c]) - mu) * rs * lg[c] + lb[c];
            vp[c] = (bf16_t)f2b(d);
            float cv = cw[2048 + c] * b2f(U[(long)r * 1024 + c]);
            if (tt >= 1) cv += cw[1024 + c] * b2f(U[(long)(r - 1) * 1024 + c]);
            if (tt >= 2) cv += cw[c] * b2f(U[(long)(r - 2) * 1024 + c]);
            bf16_t* yp = Y + (long)r * 2048 + c;
            *yp = (bf16_t)f2b(b2f(*yp) * cv);
          }
        }
      }
      grid.sync();
      for (int t = blockIdx.x; t < 256 * 8; t += gridDim.x) {
        int ch = t >> 3, g = t & 7;
        const float* Ap = P.e_ws + (long)lj * 8 * 16384 + (long)g * 16384;
        const bf16_t* Bp = V + (long)ch * 128 * 1024 + g * 128;
        const float* bs = P.e_bs + lj * 1024;
        gemm_tile<4, true, false, false, true>(Ap, 128, Bp, 1024, 128, 0, 32, 64, 96, BIGC, As, Bs,
          [&](int row, int cj, float v0, float v1, float v2, float v3) {
            float b = bs[row * 8 + g];
            bf16_t* yp = Y + ((long)ch * 128 + row) * 2048 + 1024 + g * 128 + cj;
            yp[0] = (bf16_t)f2b(b2f(yp[0]) * (v0 + b));
            yp[32] = (bf16_t)f2b(b2f(yp[32]) * (v1 + b));
            yp[64] = (bf16_t)f2b(b2f(yp[64]) * (v2 + b));
            yp[96] = (bf16_t)f2b(b2f(yp[96]) * (v3 + b));
          });
      }
      grid.sync();
    } else {
      const float* w_in = P.o_w_in + (long)lj * 1024 * 8208;
      w_out = P.o_w_out + (long)lj * 2048 * 1024;
      const float* bif = P.o_bif + lj * 16;
      const float* mhg = P.o_mhg + lj * 2048;
      for (int bb = 0; bb < 2; bb++) {
        const long tok0 = (long)bb * SEQ;
        for (int t = blockIdx.x; t < 128 * 65; t += gridDim.x) {
          int rt = t / 65, ct = t % 65;
          const bf16_t* Ap = R1 + (tok0 + (long)rt * 128) * 1024;
          long r0 = (long)rt * 128;
          if (ct < 8) {
            int j0 = ct * 128;
            gemm_tile<4, false, true, false, false>(Ap, 1024, w_in, 8208, 1024, j0, j0 + 32, j0 + 64, j0 + 96, BIGC, As, Bs,
              [&](int row, int cj, float v0, float v1, float v2, float v3) {
                bf16_t* q = Qb + (r0 + row) * 1024 + j0 + cj;
                const float sc = 0.08838834764831845f;
                q[0] = (bf16_t)f2b(v0 * sc); q[32] = (bf16_t)f2b(v1 * sc); q[64] = (bf16_t)f2b(v2 * sc); q[96] = (bf16_t)f2b(v3 * sc);
              });
          } else if (ct < 16) {
            int j0 = (ct - 8) * 128;
            gemm_tile<4, false, true, false, false>(Ap, 1024, w_in, 8208, 1024, 1024 + j0, 1024 + j0 + 32, 1024 + j0 + 64, 1024 + j0 + 96, BIGC, As, Bs,
              [&](int row, int cj, float v0, float v1, float v2, float v3) {
                bf16_t* q = Kb + (r0 + row) * 1024 + j0 + cj;
                q[0] = (bf16_t)f2b(v0); q[32] = (bf16_t)f2b(v1); q[64] = (bf16_t)f2b(v2); q[96] = (bf16_t)f2b(v3);
              });
          } else if (ct < 32) {
            int j0 = (ct - 16) * 128;
            gemm_tile<4, false, true, false, false>(Ap, 1024, w_in, 8208, 1024, 2048 + j0, 2048 + j0 + 32, 2048 + j0 + 64, 2048 + j0 + 96, BIGC, As, Bs,
              [&](int row, int cj, float v0, float v1, float v2, float v3) {
                bf16_t* q = Vb + (r0 + row) * 2048 + j0 + cj;
                q[0] = (bf16_t)f2b(v0); q[32] = (bf16_t)f2b(v1); q[64] = (bf16_t)f2b(v2); q[96] = (bf16_t)f2b(v3);
              });
          } else if (ct < 64) {
            int j0 = (ct - 32) * 64;
            gemm_tile<4, false, true, false, false>(Ap, 1024, w_in, 8208, 1024, 4096 + j0, 4096 + j0 + 32, 6144 + j0, 6144 + j0 + 32, BIGC, As, Bs,
              [&](int row, int cj, float v0, float v1, float v2, float v3) {
                bf16_t* q = Y + (tok0 + r0 + row) * 2048 + j0 + cj;
                q[0] = (bf16_t)f2b(sigm(v0) * silu(v2));
                q[32] = (bf16_t)f2b(sigm(v1) * silu(v3));
              });
          } else {
            gemm_tile<1, false, true, false, false>(Ap, 1024, w_in, 8208, 1024, 8192, 0, 0, 0, 8207, As, Bs,
              [&](int row, int cj, float v0, float v1, float v2, float v3) {
                if (cj < 16) GATE[(r0 + row) * 16 + cj] = v0 + bif[cj];
              });
          }
        }
        grid.sync();
        for (int it = gtid; it < 1024; it += gsz) {
          int n = it >> 3, h = it & 7;
          float b = 0.f, pm = -INFINITY;
          for (int s = 0; s < 128; s++) {
            long tk = (long)n * 128 + s;
            float ip = GATE[tk * 16 + h], fp = GATE[tk * 16 + 8 + h];
            float lf = fminf(fp, 0.f) - log1pf(__expf(-fabsf(fp)));
            b += lf;
            pm = fmaxf(pm, ip - b);
            Bc[tk * 8 + h] = b; IP[tk * 8 + h] = ip; Mloc[tk * 8 + h] = b + pm;
          }
          float g = b, am = -INFINITY;
          for (int s = 0; s < 128; s++) {
            long tk = (long)n * 128 + s;
            float a = g - Bc[tk * 8 + h] + IP[tk * 8 + h];
            Aar[tk * 8 + h] = a;
            am = fmaxf(am, a);
          }
          Gc[it] = g; AMX[it] = am;
        }
        for (int it = gtid; it < 262144; it += gsz) Cst[it] = 0.f;
        for (int it = gtid; it < 1024; it += gsz) Nst[it] = 0.f;
        if (gtid < 8) Mst[gtid] = 0.f;
        grid.sync();
        for (int n = 0; n < 128; n++) {
          const int cur = n & 1, nxt = cur ^ 1;
          const float* Cc = Cst + cur * 262144; float* Cn = Cst + nxt * 262144;
          const float* Nc = Nst + cur * 1024; float* Nn = Nst + nxt * 1024;
          float4* qs4 = (float4*)As;
          float4* kw4 = (float4*)Bs;
          for (int item = blockIdx.x; item < 256; item += gridDim.x) {
            const int h = item >> 5, r0 = (item & 31) * 4;
            float m_old = Mst[cur * 8 + h];
            float gg = Gc[n * 8 + h], am = AMX[n * 8 + h];
            float m_new = fmaxf(gg + m_old, am);
            float decay = __expf(gg + m_old - m_new);
            __syncthreads();
            if (tid < 128) {
              int s = tid;
              float w = __expf(Aar[((long)n * 128 + s) * 8 + h] - m_new);
              const bf16_t* kp = Kb + ((long)n * 128 + s) * 1024 + h * 128 + r0;
              kw4[s] = make_float4(b2f(kp[0]) * w, b2f(kp[1]) * w, b2f(kp[2]) * w, b2f(kp[3]) * w);
            } else {
              int kd = tid - 128;
              const bf16_t* qp = Qb + ((long)n * 128 + r0) * 1024 + h * 128 + kd;
              qs4[kd] = make_float4(b2f(qp[0]), b2f(qp[1024]), b2f(qp[2048]), b2f(qp[3072]));
            }
            __syncthreads();
            const int v = tid;
            const float* cp = Cc + h * 32768 + v;
            float a10 = 0.f, a11 = 0.f, a12 = 0.f, a13 = 0.f;
#pragma unroll 2
            for (int kd = 0; kd < 128; kd++) {
              float c = cp[kd * 256]; float4 q = qs4[kd];
              a10 += q.x * c; a11 += q.y * c; a12 += q.z * c; a13 += q.w * c;
            }
            const bf16_t* vp = Vb + ((long)n * 128) * 2048 + h * 256 + v;
            float a20 = 0.f, a21 = 0.f, a22 = 0.f, a23 = 0.f;
#pragma unroll 2
            for (int s = 0; s < 128; s++) {
              float vv = b2f(vp[s * 2048]); float4 k = kw4[s];
              a20 += k.x * vv; a21 += k.y * vv; a22 += k.z * vv; a23 += k.w * vv;
            }
            {
              const float* co = Cc + h * 32768 + r0 * 256 + v; float* cn = Cn + h * 32768 + r0 * 256 + v;
              cn[0] = decay * co[0] + a20; cn[256] = decay * co[256] + a21; cn[512] = decay * co[512] + a22; cn[768] = decay * co[768] + a23;
              bf16_t* qc = QC + ((long)n * 128 + r0) * 2048 + h * 256 + v;
              qc[0] = (bf16_t)f2b(a10); qc[2048] = (bf16_t)f2b(a11); qc[4096] = (bf16_t)f2b(a12); qc[6144] = (bf16_t)f2b(a13);
            }
            {
              int wv = tid >> 6, ln = tid & 63;
              float4 k0 = kw4[ln], k1 = kw4[ln + 64], q0 = qs4[ln], q1 = qs4[ln + 64];
              float n0 = Nc[h * 128 + ln], n1 = Nc[h * 128 + ln + 64];
              float kk = wv == 0 ? k0.x + k1.x : wv == 1 ? k0.y + k1.y : wv == 2 ? k0.z + k1.z : k0.w + k1.w;
              float qq = wv == 0 ? q0.x * n0 + q1.x * n1 : wv == 1 ? q0.y * n0 + q1.y * n1 : wv == 2 ? q0.z * n0 + q1.z * n1 : q0.w * n0 + q1.w * n1;
              kk = wave_sum(kk); qq = wave_sum(qq);
              if (ln == 0) {
                QN[((long)n * 128 + r0 + wv) * 8 + h] = qq;
                Nn[h * 128 + r0 + wv] = decay * Nc[h * 128 + r0 + wv] + kk;
              }
              if (tid == 0 && r0 == 0) { MALL[n * 8 + h] = m_old; Mst[nxt * 8 + h] = m_new; }
            }
          }
          grid.sync();
        }
        for (int t = blockIdx.x; t < 1024; t += gridDim.x) {
          int n = t >> 3, h = t & 7;
          const bf16_t* Ap = Qb + (long)n * 128 * 1024 + h * 128;
          const bf16_t* Bp = Kb + (long)n * 128 * 1024 + h * 128;
          float mall = MALL[t];
          gemm_tile<4, false, false, true, false>(Ap, 1024, Bp, 1024, 128, 0, 32, 64, 96, BIGC, As, Bs,
            [&](int row, int cj, float v0, float v1, float v2, float v3) {
              long tk = (long)n * 128 + row;
              float bt = Bc[tk * 8 + h];
              float mt = fmaxf(bt + mall, Mloc[tk * 8 + h]);
              bf16_t* pp = Pm + ((long)t * 128 + row) * 128 + cj;
              float vv[4] = {v0, v1, v2, v3};
#pragma unroll
              for (int q = 0; q < 4; q++) {
                int s = cj + 32 * q;
                float pv = 0.f;
                if (s <= row) {
                  long ts = (long)n * 128 + s;
                  pv = __expf(bt - Bc[ts * 8 + h] + IP[ts * 8 + h] - mt) * vv[q];
                }
                pp[32 * q] = (bf16_t)f2b(pv);
              }
            });
        }
        grid.sync();
        for (int it = gtid; it < 131072; it += gsz) {
          int row = it & 127, h = (it >> 7) & 7, n = it >> 10;
          long tk = (long)n * 128 + row;
          const bf16_t* pp = Pm + ((long)(n * 8 + h) * 128 + row) * 128;
          float rsum = 0.f;
          for (int s = 0; s < 128; s++) rsum += b2f(pp[s]);
          float mi = Bc[tk * 8 + h] + MALL[n * 8 + h];
          float mt = fmaxf(mi, Mloc[tk * 8 + h]);
          float isc = __expf(mi - mt);
          float den = isc * QN[tk * 8 + h] + rsum;
          float dn = fmaxf(fabsf(den), __expf(-mt));
          ISC[tk * 8 + h] = isc / dn; RDN[tk * 8 + h] = 1.f / dn;
        }
        grid.sync();
        for (int t = blockIdx.x; t < 2048; t += gridDim.x) {
          int half = t & 1, nh = t >> 1, n = nh >> 3, h = nh & 7;
          const bf16_t* Ap = Pm + (long)nh * 128 * 128;
          const bf16_t* Bp = Vb + (long)n * 128 * 2048 + h * 256 + half * 128;
          gemm_tile<4, false, false, false, false>(Ap, 128, Bp, 2048, 128, 0, 32, 64, 96, BIGC, As, Bs,
            [&](int row, int cj, float v0, float v1, float v2, float v3) {
              long tk = (long)n * 128 + row;
              float isc = ISC[tk * 8 + h], rdn = RDN[tk * 8 + h];
              bf16_t* qp = QC + tk * 2048 + h * 256 + half * 128 + cj;
              qp[0] = (bf16_t)f2b(isc * b2f(qp[0]) + rdn * v0);
              qp[32] = (bf16_t)f2b(isc * b2f(qp[32]) + rdn * v1);
              qp[64] = (bf16_t)f2b(isc * b2f(qp[64]) + rdn * v2);
              qp[96] = (bf16_t)f2b(isc * b2f(qp[96]) + rdn * v3);
            });
        }
        grid.sync();
        {
          int lane = tid & 63; int wid = gtid >> 6, nw = gsz >> 6;
          for (int it = wid; it < SEQ * 8; it += nw) {
            int h = it & 7; long tk = it >> 3;
            const bf16_t* hp = QC + tk * 2048 + h * 256;
            float x0 = b2f(hp[lane]), x1 = b2f(hp[lane + 64]), x2 = b2f(hp[lane + 128]), x3 = b2f(hp[lane + 192]);
            float ss = wave_sum(x0 * x0 + x1 * x1 + x2 * x2 + x3 * x3);
            float rs = rsqrtf(ss * (1.f / 256.f) + EPSF);
            bf16_t* yp = Y + (tok0 + tk) * 2048 + h * 256;
            const float* gp = mhg + h * 256;
            yp[lane] = (bf16_t)f2b(b2f(yp[lane]) * x0 * rs * gp[lane]);
            yp[lane + 64] = (bf16_t)f2b(b2f(yp[lane + 64]) * x1 * rs * gp[lane + 64]);
            yp[lane + 128] = (bf16_t)f2b(b2f(yp[lane + 128]) * x2 * rs * gp[lane + 128]);
            yp[lane + 192] = (bf16_t)f2b(b2f(yp[lane + 192]) * x3 * rs * gp[lane + 192]);
          }
        }
        grid.sync();
      }
    }
    for (int t = blockIdx.x; t < 256 * 8; t += gridDim.x) {
      int rt = t >> 3, ct = t & 7;
      int j0 = ct * 128; long r0 = (long)rt * 128;
      gemm_tile<4, false, true, false, false>(Y + r0 * 2048, 2048, w_out, 1024, 2048, j0, j0 + 32, j0 + 64, j0 + 96, BIGC, As, Bs,
        [&](int row, int cj, float v0, float v1, float v2, float v3) {
          float* yp = YP + (r0 + row) * 1024 + j0 + cj;
          yp[0] = v0; yp[32] = v1; yp[64] = v2; yp[96] = v3;
        });
    }
    grid.sync();
    ph_post(hsrc, YP, P.post_g + layer * 1024, P.ple_g + layer * 1024, P.out, R1);
    for (int t = blockIdx.x; t < 256 * 8; t += gridDim.x) {
      int rt = t >> 3, ct = t & 7;
      int j0 = ct * 128; long r0 = (long)rt * 128;
      gemm_tile<4, true, true, false, false>(P.p + ((long)layer * NTOK + r0) * 256, 256, P.w_ple + (long)layer * 256 * 1024, 1024, 256,
        j0, j0 + 32, j0 + 64, j0 + 96, BIGC, As, Bs,
        [&](int row, int cj, float v0, float v1, float v2, float v3) {
          float* yp = PE + (r0 + row) * 1024 + j0 + cj;
          yp[0] = v0; yp[32] = v1; yp[64] = v2; yp[96] = v3;
        });
    }
    grid.sync();
    for (int t = blockIdx.x; t < 256 * 8; t += gridDim.x) {
      int rt = t >> 3, ct = t & 7;
      int j0 = ct * 128; long r0 = (long)rt * 128;
      gemm_tile<4, false, true, false, false>(R1 + r0 * 1024, 1024, P.w_ple_gate + (long)layer * 1024 * 1024, 1024, 1024,
        j0, j0 + 32, j0 + 64, j0 + 96, BIGC, As, Bs,
        [&](int row, int cj, float v0, float v1, float v2, float v3) {
          long o = (r0 + row) * 1024 + j0 + cj;
          P.out[o] += sigm(v0) * PE[o];
          P.out[o + 32] += sigm(v1) * PE[o + 32];
          P.out[o + 64] += sigm(v2) * PE[o + 64];
          P.out[o + 96] += sigm(v3) * PE[o + 96];
        });
    }
    grid.sync();
  }
}

extern "C" void kernel_launch(void* const* d_in, const int* in_sizes, int n_in, void* d_out, int out_size, void* d_ws, size_t ws_size,
                              hipStream_t stream) {
  Prm P;
  P.x = (const float*)d_in[0]; P.p = (const float*)d_in[1]; P.pre_g = (const float*)d_in[2]; P.post_g = (const float*)d_in[3];
  P.ple_g = (const float*)d_in[4]; P.w_ple = (const float*)d_in[5]; P.w_ple_gate = (const float*)d_in[6]; P.e_w_in = (const float*)d_in[7];
  P.e_conv = (const float*)d_in[8]; P.e_ln_g = (const float*)d_in[9]; P.e_ln_b = (const float*)d_in[10]; P.e_ws = (const float*)d_in[11];
  P.e_bs = (const float*)d_in[12]; P.e_w_out = (const float*)d_in[13]; P.o_w_in = (const float*)d_in[14]; P.o_bif = (const float*)d_in[15];
  P.o_mhg = (const float*)d_in[16]; P.o_w_out = (const float*)d_in[17];
  P.out = (float*)d_out; P.ws = (char*)d_ws;
  int dev = 0; hipGetDevice(&dev);
  hipDeviceProp_t prop; hipGetDeviceProperties(&prop, dev);
  int occ = 0;
  hipOccupancyMaxActiveBlocksPerMultiprocessor(&occ, (const void*)mega, NTH, 0);
  if (occ < 1) occ = 1;
  if (occ > 2) occ = 2;
  int nblk = occ * prop.multiProcessorCount;
  void* args[] = {&P};
  hipLaunchCooperativeKernel((const void*)mega, dim3(nblk), dim3(NTH), args, 0, stream);
}
```
